# Optimizing an MI355X kernel written in HIP

```python
import math
import jax
import jax.numpy as jnp
from jax import lax
import numpy as np

D_MODEL = 1024
BATCH = 4
SEQ = 4096
DEPTH = 2

N_MIXERS = 2
POOL_WINDOWS = (2, 4, 8, 16)
N_POOL_GROUPS = len(POOL_WINDOWS)
POOL_GROUP_DIM = D_MODEL // N_POOL_GROUPS
HEAD_DIM = 64
N_HEADS = D_MODEL // HEAD_DIM
DIL_CONFIGS = ((128, 1), (512, 4), (2048, 16))
N_DIL_GROUPS = len(DIL_CONFIGS)
ATTN_WIDTH = N_HEADS * HEAD_DIM
QKV_WIDTH = N_DIL_GROUPS * 3 * ATTN_WIDTH
D_FF = 2816
MACARON_WEIGHT = 0.5
ALPHA = (2.0 * DEPTH) ** 0.25
BETA = (8.0 * DEPTH) ** -0.25
LN_EPS = 1e-5
MASK_VALUE = -1e30

kernel_name = "hybrid_pool_dilated_attn_macaron_deepnorm"


def _alibi_slopes():
    n = N_DIL_GROUPS * N_HEADS
    s = 2.0 ** (-8.0 * np.arange(1, n + 1) / n)
    return s.reshape(N_DIL_GROUPS, N_HEADS).astype(np.float32)


def _layer_norm(x, g, b):
    x32 = x.astype(jnp.float32)
    mu = jnp.mean(x32, axis=-1, keepdims=True)
    var = jnp.mean(jnp.square(x32 - mu), axis=-1, keepdims=True)
    y = (x32 - mu) * lax.rsqrt(var + LN_EPS)
    return (y * g.astype(jnp.float32) + b.astype(jnp.float32)).astype(x.dtype)


def _swiglu(x, w_gate, w_up, w_down):
    return (jax.nn.silu(x @ w_gate) * (x @ w_up)) @ w_down


def _pool_mixer(x, w_in, w_group, scale, w_out):
    B, S, _ = x.shape
    u = (x @ w_in).reshape(B, S, N_POOL_GROUPS, POOL_GROUP_DIM).astype(jnp.float32)
    csum = jnp.concatenate([jnp.zeros_like(u[:, :1]), jnp.cumsum(u, axis=1)], axis=1)
    half = jnp.asarray([w // 2 for w in POOL_WINDOWS], dtype=jnp.int32)
    t = jnp.arange(S, dtype=jnp.int32)[:, None]
    lo = jnp.clip(t - half[None, :], 0, S)
    hi = jnp.clip(t + half[None, :], 0, S)
    gidx = jnp.arange(N_POOL_GROUPS)[None, :]
    win_sum = csum[:, hi, gidx] - csum[:, lo, gidx]
    mean = win_sum / (hi - lo).astype(jnp.float32)[None, :, :, None]
    mixed = (mean - u).astype(x.dtype)
    y = jnp.einsum('bsgc,gce->bsge', mixed, w_group).reshape(B, S, D_MODEL) * scale
    return y @ w_out


def _dilated_group(q, k, v, window, dilation, slopes):
    B, S, H, E = q.shape
    d = dilation
    L = S // d
    R = window // (2 * d)
    W = R
    nb = -(-L // W)
    Lp = nb * W

    def to_sub(a):
        return a.reshape(B, L, d, H, E).transpose(0, 2, 3, 1, 4)

    qs = jnp.pad(to_sub(q), ((0, 0),) * 3 + ((0, Lp - L), (0, 0))).reshape(B, d, H, nb, W, E)

    def windows(a):
        ap = jnp.pad(to_sub(a), ((0, 0),) * 3 + ((W, W + Lp - L), (0, 0)))
        ap = ap.reshape(B, d, H, nb + 2, W, E)
        return jnp.concatenate([ap[:, :, :, :-2], ap[:, :, :, 1:-1], ap[:, :, :, 2:]], axis=4)

    kw = windows(k)
    vw = windows(v)
    a_idx = jnp.arange(W)
    c_idx = jnp.arange(3 * W)
    n_idx = jnp.arange(nb)
    rel = c_idx[None, :] - W - a_idx[:, None]
    j = (n_idx[:, None, None] - 1) * W + c_idx[None, None, :]
    valid = (jnp.abs(rel)[None] <= R) & (j >= 0) & (j < L)
    dist = (d * jnp.abs(rel)).astype(jnp.float32)
    bias = -slopes[:, None, None] * dist[None]
    scores = jnp.einsum('bdhnqe,bdhnke->bdhnqk', qs.astype(jnp.float32),
                        kw.astype(jnp.float32)) * (E ** -0.5) + bias[:, None]
    scores = jnp.where(valid, scores, MASK_VALUE)
    lse = jax.nn.logsumexp(scores, axis=-1)
    p = jnp.exp(scores - lse[..., None])
    o = jnp.einsum('bdhnqk,bdhnke->bdhnqe', p, vw.astype(jnp.float32))
    o = o.reshape(B, d, H, Lp, E)[:, :, :, :L].transpose(0, 3, 1, 2, 4).reshape(B, S, H, E)
    lse = lse.reshape(B, d, H, Lp)[..., :L].transpose(0, 3, 1, 2).reshape(B, S, H)
    return o, lse


def _dilated_attention_mixer(x, w_qkv, w_out):
    B, S, _ = x.shape
    qkv = (x @ w_qkv).reshape(B, S, N_DIL_GROUPS, 3, N_HEADS, HEAD_DIM)
    slopes = jnp.asarray(_alibi_slopes())
    outs, lses = [], []
    for g, (window, dil) in enumerate(DIL_CONFIGS):
        o, l = _dilated_group(qkv[:, :, g, 0], qkv[:, :, g, 1], qkv[:, :, g, 2],
                              window, dil, slopes[g])
        outs.append(o)
        lses.append(l)
    wts = jax.nn.softmax(jnp.stack(lses), axis=0)
    o = jnp.sum(wts[..., None] * jnp.stack(outs), axis=0)
    return o.reshape(B, S, ATTN_WIDTH).astype(x.dtype) @ w_out


def setup_inputs(seed: int = 0) -> dict:
    key = jax.random.key(seed)
    ks = jax.random.split(key, 16)
    n_pool = (DEPTH + 1) // 2
    n_attn = DEPTH // 2
    f32 = jnp.float32

    def nrm(k, shape, scale):
        return jax.random.normal(k, shape, f32) * scale

    return {
        "x": jax.random.normal(ks[0], (BATCH, SEQ, D_MODEL), f32),
        "ffn1_w_gate": nrm(ks[1], (DEPTH, D_MODEL, D_FF), D_MODEL ** -0.5),
        "ffn1_w_up": nrm(ks[2], (DEPTH, D_MODEL, D_FF), D_MODEL ** -0.5),
        "ffn1_w_down": nrm(ks[3], (DEPTH, D_FF, D_MODEL), BETA * D_FF ** -0.5),
        "ffn2_w_gate": nrm(ks[4], (DEPTH, D_MODEL, D_FF), D_MODEL ** -0.5),
        "ffn2_w_up": nrm(ks[5], (DEPTH, D_MODEL, D_FF), D_MODEL ** -0.5),
        "ffn2_w_down": nrm(ks[6], (DEPTH, D_FF, D_MODEL), BETA * D_FF ** -0.5),
        "ln_gain": 1.0 + nrm(ks[7], (DEPTH, 3, D_MODEL), 0.02),
        "ln_bias": nrm(ks[8], (DEPTH, 3, D_MODEL), 0.02),
        "pool_w_in": nrm(ks[9], (n_pool, D_MODEL, D_MODEL), D_MODEL ** -0.5),
        "pool_w_group": nrm(ks[10], (n_pool, N_POOL_GROUPS, POOL_GROUP_DIM, POOL_GROUP_DIM),
                            POOL_GROUP_DIM ** -0.5),
        "pool_scale": 1.0 + nrm(ks[11], (n_pool, D_MODEL), 0.1),
        "pool_w_out": nrm(ks[12], (n_pool, D_MODEL, D_MODEL), BETA * D_MODEL ** -0.5),
        "attn_w_qkv": nrm(ks[13], (n_attn, D_MODEL, QKV_WIDTH), D_MODEL ** -0.5),
        "attn_w_out": nrm(ks[14], (n_attn, ATTN_WIDTH, D_MODEL), BETA * ATTN_WIDTH ** -0.5),
    }


def reference(x, ffn1_w_gate, ffn1_w_up, ffn1_w_down, ffn2_w_gate, ffn2_w_up, ffn2_w_down,
              ln_gain, ln_bias, pool_w_in, pool_w_group, pool_scale, pool_w_out,
              attn_w_qkv, attn_w_out):
    for i in range(DEPTH):
        h = _swiglu(x, ffn1_w_gate[i], ffn1_w_up[i], ffn1_w_down[i])
        x = _layer_norm(ALPHA * x + MACARON_WEIGHT * h, ln_gain[i, 0], ln_bias[i, 0])
        if i % N_MIXERS == 0:
            p = i // N_MIXERS
            m = _pool_mixer(x, pool_w_in[p], pool_w_group[p], pool_scale[p], pool_w_out[p])
        else:
            a = i // N_MIXERS
            m = _dilated_attention_mixer(x, attn_w_qkv[a], attn_w_out[a])
        x = _layer_norm(ALPHA * x + m, ln_gain[i, 1], ln_bias[i, 1])
        h = _swiglu(x, ffn2_w_gate[i], ffn2_w_up[i], ffn2_w_down[i])
        x = _layer_norm(ALPHA * x + MACARON_WEIGHT * h, ln_gain[i, 2], ln_bias[i, 2])
    return x
```

```cpp
#include <hip/hip_runtime.h>
#include <cstdio>
#include <cstdint>
constexpr int DM = 1024, BATCH = 4, SEQ = 4096, M = BATCH * SEQ, DFF = 2816, DEPTH = 2;
constexpr int QKVW = 9216, GW = 3072;
constexpr float ALPHA = 1.4142135623730951f, MACARON = 0.5f, LN_EPS = 1e-5f;
constexpr size_t MiB = 1u << 20;
constexpr size_t WS_CTL = 0, CTL_ZERO_BYTES = 1 * MiB;
constexpr size_t WS_XCH = 1 * MiB;
constexpr size_t WS_W = 4 * MiB;
constexpr size_t W_GU_BYTES = (size_t)2 * DFF * DM * 2, W_DN_BYTES = (size_t)DM * DFF * 2, W_SQ_BYTES = (size_t)DM * DM * 2;
constexpr size_t WO_GU0 = 0, WO_DN0 = WO_GU0 + 4 * W_GU_BYTES;
constexpr size_t WO_PIN = WO_DN0 + 4 * W_DN_BYTES, WO_PGRP = WO_PIN + W_SQ_BYTES, WO_POUT = WO_PGRP + (size_t)4 * 256 * 256 * 2;
constexpr size_t WO_QKV = WO_POUT + W_SQ_BYTES, WO_AOUT = WO_QKV + (size_t)QKVW * DM * 2, WO_END = WO_AOUT + W_SQ_BYTES;
constexpr size_t WS_XB = 95 * MiB;
constexpr size_t WS_BIG = 127 * MiB;
constexpr size_t WS_O = 223 * MiB;
constexpr size_t WS_LSE = 255 * MiB;
constexpr size_t WS_END = 256 * MiB;
static_assert(WS_W + WO_END <= WS_XB, "weights fit");
static_assert((size_t)M * DFF * 2 <= 96 * MiB && (size_t)M * GW * 2 <= 96 * MiB, "BIG region");
constexpr size_t BIG_U = 0, BIG_MIX = 64 * MiB, BIG_Y = 0;
namespace nv {
typedef unsigned short bf16;
__device__ __forceinline__ float bf2f(bf16 v) { return __uint_as_float(((unsigned)v) << 16); }
__device__ __forceinline__ bf16 f2bf(float f) { unsigned u = __float_as_uint(f); return (bf16)((u + 0x7fffu + ((u >> 16) & 1u)) >> 16); }

__global__ void __launch_bounds__(256) k_cvt(const float* __restrict__ x, bf16* __restrict__ xb, size_t n) {
    size_t i = (size_t)blockIdx.x * 256 + threadIdx.x;
    for (; i < n; i += (size_t)gridDim.x * 256) xb[i] = f2bf(x[i]);
}

struct NG {
    const bf16* A; int lda;
    const float* B; const float* B2; int ldb;
    int K;
    bf16* Ob; int ldob;
    float* Of; int ldof;
    const float* res;
    const float* gain; const float* bias; const float* scale;
    float alpha, sc;
};
template <int CPT, int MODE>
__global__ void __launch_bounds__(256) k_gemm(NG p) {
    __shared__ float As[16][33];
    __shared__ float red[16][4];
    const int tid = threadIdx.x;
    const int row0 = blockIdx.y * 16, col0 = blockIdx.x * 256 * CPT + tid * CPT;
    float acc[16][CPT];
    float acc2[16][CPT];
#pragma unroll
    for (int r = 0; r < 16; ++r)
#pragma unroll
        for (int j = 0; j < CPT; ++j) { acc[r][j] = 0.f; acc2[r][j] = 0.f; }
    for (int k0 = 0; k0 < p.K; k0 += 32) {
#pragma unroll
        for (int i = 0; i < 2; ++i) { const int e = tid + i * 256, r = e >> 5, c = e & 31; As[r][c] = bf2f(p.A[(size_t)(row0 + r) * p.lda + k0 + c]); }
        __syncthreads();
#pragma unroll 4
        for (int kk = 0; kk < 32; ++kk) {
            float b[CPT], b2[CPT];
#pragma unroll
            for (int j = 0; j < CPT; ++j) { b[j] = p.B[(size_t)(k0 + kk) * p.ldb + col0 + j]; b2[j] = (MODE == 0) ? p.B2[(size_t)(k0 + kk) * p.ldb + col0 + j] : 0.f; }
#pragma unroll
            for (int r = 0; r < 16; ++r) { const float a = As[r][kk];
#pragma unroll
                for (int j = 0; j < CPT; ++j) { acc[r][j] += a * b[j]; if (MODE == 0) acc2[r][j] += a * b2[j]; } }
        }
        __syncthreads();
    }
    if (MODE == 0) {
#pragma unroll
        for (int r = 0; r < 16; ++r)
#pragma unroll
            for (int j = 0; j < CPT; ++j) { const float g = acc[r][j], u = acc2[r][j]; const float s = g / (1.f + __expf(-g)); p.Ob[(size_t)(row0 + r) * p.ldob + col0 + j] = f2bf(s * u); }
    } else if (MODE == 1) {
        const int lane = tid & 63, w = tid >> 6;
        float mean[16], rstd[16];
#pragma unroll
        for (int r = 0; r < 16; ++r) { float s = 0.f;
#pragma unroll
            for (int j = 0; j < CPT; ++j) { acc[r][j] = p.alpha * p.res[(size_t)(row0 + r) * 1024 + col0 + j] + p.sc * acc[r][j]; s += acc[r][j]; }
#pragma unroll
            for (int o = 1; o < 64; o <<= 1) s += __shfl_xor(s, o);
            if (lane == 0) red[r][w] = s; }
        __syncthreads();
#pragma unroll
        for (int r = 0; r < 16; ++r) mean[r] = (red[r][0] + red[r][1] + red[r][2] + red[r][3]) * (1.f / 1024.f);
        __syncthreads();
#pragma unroll
        for (int r = 0; r < 16; ++r) { float s = 0.f;
#pragma unroll
            for (int j = 0; j < CPT; ++j) { const float d = acc[r][j] - mean[r]; s += d * d; }
#pragma unroll
            for (int o = 1; o < 64; o <<= 1) s += __shfl_xor(s, o);
            if (lane == 0) red[r][w] = s; }
        __syncthreads();
#pragma unroll
        for (int r = 0; r < 16; ++r) rstd[r] = 1.f / sqrtf((red[r][0] + red[r][1] + red[r][2] + red[r][3]) * (1.f / 1024.f) + 1e-5f);
#pragma unroll
        for (int r = 0; r < 16; ++r)
#pragma unroll
            for (int j = 0; j < CPT; ++j) { const float y = (acc[r][j] - mean[r]) * rstd[r] * p.gain[col0 + j] + p.bias[col0 + j];
                p.Of[(size_t)(row0 + r) * p.ldof + col0 + j] = y; p.Ob[(size_t)(row0 + r) * p.ldob + col0 + j] = f2bf(y); }
    } else if (MODE == 2) {
#pragma unroll
        for (int r = 0; r < 16; ++r)
#pragma unroll
            for (int j = 0; j < CPT; ++j) p.Of[(size_t)(row0 + r) * p.ldof + col0 + j] = acc[r][j];
    } else {
#pragma unroll
        for (int r = 0; r < 16; ++r)
#pragma unroll
            for (int j = 0; j < CPT; ++j) { const float sc = (MODE == 3) ? p.scale[col0 + j] : 1.f; p.Ob[(size_t)(row0 + r) * p.ldob + col0 + j] = f2bf(acc[r][j] * sc); }
    }
}

__global__ void __launch_bounds__(256) k_pool(const float* __restrict__ U, bf16* __restrict__ MIX) {
    const int t = blockIdx.x, b = t >> 12, s = t & 4095;
    for (int c = threadIdx.x; c < 1024; c += 256) {
        const int h = 1 << (c >> 8);
        const int lo = max(s - h, 0), hi = min(s + h, 4096);
        float sum = 0.f;
        for (int q = lo; q < hi; ++q) sum += U[((size_t)(b * 4096 + q)) * 1024 + c];
        MIX[(size_t)t * 1024 + c] = f2bf(sum / (float)(hi - lo) - U[(size_t)t * 1024 + c]);
    }
}

__global__ void __launch_bounds__(256) k_attn(const bf16* __restrict__ QKV, bf16* __restrict__ O, float* __restrict__ LSE, int g) {
    const int lane = threadIdx.x & 63, w = threadIdx.x >> 6;
    const int idx = blockIdx.x * 4 + w;
    const int t = idx >> 4, h = idx & 15, s = t & 4095;
    const int d = (g == 0) ? 1 : (g == 1 ? 4 : 16);
    const float slope = exp2f(-8.0f * (float)(g * 16 + h + 1) / 48.0f);
    const float q = bf2f(QKV[(size_t)t * 3072 + h * 64 + lane]) * 0.125f;
    float m = -1e30f, l = 0.f, acc = 0.f;
    for (int j = -64; j <= 64; ++j) {
        const int sk = s + j * d;
        if (sk < 0 || sk >= 4096) continue;
        const size_t tk = (size_t)(t + j * d);
        float sc = q * bf2f(QKV[tk * 3072 + 1024 + h * 64 + lane]);
#pragma unroll
        for (int o = 1; o < 64; o <<= 1) sc += __shfl_xor(sc, o);
        sc -= slope * (float)(d * (j < 0 ? -j : j));
        const float mn = fmaxf(m, sc);
        const float f = __expf(m - mn), pj = __expf(sc - mn);
        l = l * f + pj; acc = acc * f + pj * bf2f(QKV[tk * 3072 + 2048 + h * 64 + lane]); m = mn;
    }
    float o = acc / l, lse = m + __logf(l);
    if (g > 0) {
        const float lp = LSE[(size_t)t * 16 + h], op = bf2f(O[(size_t)t * 1024 + h * 64 + lane]);
        const float mx = fmaxf(lp, lse), a = __expf(lp - mx), b = __expf(lse - mx), inv = 1.f / (a + b);
        o = (op * a + o * b) * inv; lse = mx + __logf(a + b);
    }
    O[(size_t)t * 1024 + h * 64 + lane] = f2bf(o);
    if (lane == 0) LSE[(size_t)t * 16 + h] = lse;
}
}
struct In {
    const float *x, *f1g, *f1u, *f1d, *f2g, *f2u, *f2d, *lng, *lnb, *pin, *pgrp, *pscale, *pout, *wqkv, *wout;
};
static void n_gu(hipStream_t st, unsigned char* ws, const float* wg, const float* wu) {
    nv::NG p{}; p.A = (const nv::bf16*)(ws + WS_XB); p.lda = DM; p.B = wg; p.B2 = wu; p.ldb = DFF; p.K = DM;
    p.Ob = (nv::bf16*)(ws + WS_BIG); p.ldob = DFF;
    hipLaunchKernelGGL((nv::k_gemm<1, 0>), dim3(DFF / 256, M / 16), dim3(256), 0, st, p);
}
static void n_ln_gemm(hipStream_t st, unsigned char* ws, const nv::bf16* A, int lda, int K, const float* W, const float* res, float* out, const float* gain, const float* bias, float sc) {
    nv::NG p{}; p.A = A; p.lda = lda; p.B = W; p.ldb = DM; p.K = K; p.Of = out; p.ldof = DM; p.Ob = (nv::bf16*)(ws + WS_XB); p.ldob = DM;
    p.res = res; p.gain = gain; p.bias = bias; p.alpha = ALPHA; p.sc = sc;
    hipLaunchKernelGGL((nv::k_gemm<4, 1>), dim3(1, M / 16), dim3(256), 0, st, p);
}
static void n_ffn(hipStream_t st, unsigned char* ws, const float* wg, const float* wu, const float* wd, const float* res, float* out, const float* gain, const float* bias) {
    n_gu(st, ws, wg, wu);
    n_ln_gemm(st, ws, (const nv::bf16*)(ws + WS_BIG), DFF, DFF, wd, res, out, gain, bias, MACARON);
}
static void n_pool(hipStream_t st, unsigned char* ws, const In& in, float* out, const float* gain, const float* bias) {
    { nv::NG p{}; p.A = (const nv::bf16*)(ws + WS_XB); p.lda = DM; p.B = in.pin; p.ldb = DM; p.K = DM; p.Of = (float*)(ws + WS_BIG + BIG_U); p.ldof = DM;
      hipLaunchKernelGGL((nv::k_gemm<4, 2>), dim3(1, M / 16), dim3(256), 0, st, p); }
    hipLaunchKernelGGL(nv::k_pool, dim3(M), dim3(256), 0, st, (const float*)(ws + WS_BIG + BIG_U), (nv::bf16*)(ws + WS_BIG + BIG_MIX));
    for (int g = 0; g < 4; ++g) {
        nv::NG p{}; p.A = (const nv::bf16*)(ws + WS_BIG + BIG_MIX) + g * 256; p.lda = DM; p.B = in.pgrp + (size_t)g * 256 * 256; p.ldb = 256; p.K = 256;
        p.Ob = (nv::bf16*)(ws + WS_BIG + BIG_Y) + g * 256; p.ldob = DM; p.scale = in.pscale + g * 256;
        hipLaunchKernelGGL((nv::k_gemm<1, 3>), dim3(1, M / 16), dim3(256), 0, st, p);
    }
    n_ln_gemm(st, ws, (const nv::bf16*)(ws + WS_BIG + BIG_Y), DM, DM, in.pout, out, out, gain, bias, 1.0f);
}
static void n_attn(hipStream_t st, unsigned char* ws, const In& in, float* out, const float* gain, const float* bias) {
    for (int g = 0; g < 3; ++g) {
        nv::NG p{}; p.A = (const nv::bf16*)(ws + WS_XB); p.lda = DM; p.B = in.wqkv + (size_t)g * GW; p.ldb = QKVW; p.K = DM; p.Ob = (nv::bf16*)(ws + WS_BIG); p.ldob = GW;
        hipLaunchKernelGGL((nv::k_gemm<4, 4>), dim3(GW / 1024, M / 16), dim3(256), 0, st, p);
        hipLaunchKernelGGL(nv::k_attn, dim3(M * 16 / 4), dim3(256), 0, st, (const nv::bf16*)(ws + WS_BIG), (nv::bf16*)(ws + WS_O), (float*)(ws + WS_LSE), g);
    }
    n_ln_gemm(st, ws, (const nv::bf16*)(ws + WS_O), DM, DM, in.wout, out, out, gain, bias, 1.0f);
}

extern "C" void kernel_launch(void* const* d_in, const int* in_sizes, int n_in, void* d_out, int out_size, void* d_ws, size_t ws_size, hipStream_t stream) {
    if (n_in != 15 || in_sizes[0] != M * DM || out_size != M * DM || ws_size < WS_END) { fprintf(stderr, "kernel_launch: unexpected shapes (n_in %d, ws %zu)\n", n_in, ws_size); return; }
    In in{(const float*)d_in[0], (const float*)d_in[1], (const float*)d_in[2], (const float*)d_in[3], (const float*)d_in[4], (const float*)d_in[5], (const float*)d_in[6], (const float*)d_in[7],
          (const float*)d_in[8], (const float*)d_in[9], (const float*)d_in[10], (const float*)d_in[11], (const float*)d_in[12], (const float*)d_in[13], (const float*)d_in[14]};
    unsigned char* ws = (unsigned char*)d_ws; float* out = (float*)d_out;
    hipLaunchKernelGGL(nv::k_cvt, dim3(4096), dim3(256), 0, stream, in.x, (nv::bf16*)(ws + WS_XB), (size_t)M * DM);
    for (int i = 0; i < DEPTH; ++i) {
        const size_t wo = (size_t)i * DM * DFF; const float* g = in.lng + (size_t)i * 3 * DM; const float* b = in.lnb + (size_t)i * 3 * DM;
        n_ffn(stream, ws, in.f1g + wo, in.f1u + wo, in.f1d + wo, i == 0 ? in.x : out, out, g, b);
        if (i % 2 == 0) n_pool(stream, ws, in, out, g + DM, b + DM); else n_attn(stream, ws, in, out, g + DM, b + DM);
        n_ffn(stream, ws, in.f2g + wo, in.f2u + wo, in.f2d + wo, out, out, g + 2 * DM, b + 2 * DM);
    }
}
```
